# Optimizing an MI355X kernel written in HIP

```python
import math
import jax
import jax.numpy as jnp
from jax import lax
import numpy as np

D_MODEL = 1024
BATCH = 16
SEQ = 2048
DEPTH = 4

CHUNK = 64
Q_BLOCK = 128
HEAD_DIM = 64
CONV_CH = D_MODEL // 2
CONV_K = 3
FOX_HEADS = (D_MODEL // 2) // HEAD_DIM
FOX_WIDTH = FOX_HEADS * HEAD_DIM
DIFF_HEADS = D_MODEL // (2 * HEAD_DIM)
N_GROUPS = 4
EXPERTS_PER_GROUP = 8
N_EXPERTS = N_GROUPS * EXPERTS_PER_GROUP
TOP_K = 2
D_EXPERT = D_MODEL // 2
MOE_BLOCK = 128
N_EVEN = (DEPTH + 1) // 2
N_ODD = DEPTH // 2
EVEN_IN = 3 * CONV_CH + 3 * FOX_WIDTH + FOX_HEADS
ODD_IN = 3 * D_MODEL
ALPHA = (2.0 * DEPTH) ** 0.25
BETA = (8.0 * DEPTH) ** -0.25
LN_EPS = 1e-5
RMS_EPS = 1e-5
FORGET_BIAS = 3.0
NEG_INF = -1e30

kernel_name = 'hybrid_chunk_stream_block'


def layer_norm(x, g, b):
    xf = x.astype(jnp.float32)
    mu = jnp.mean(xf, axis=-1, keepdims=True)
    var = jnp.mean(jnp.square(xf - mu), axis=-1, keepdims=True)
    return ((xf - mu) * lax.rsqrt(var + LN_EPS) * g + b).astype(x.dtype)


def short_gated_conv(xv, gate_b, gate_c, conv_w):
    u = gate_c * xv
    seq = u.shape[1]
    up = jnp.pad(u, ((0, 0), (CONV_K - 1, 0), (0, 0)))
    y = up[:, 0:seq] * conv_w[:, 0]
    for j in range(1, CONV_K):
        y = y + up[:, j:j + seq] * conv_w[:, j]
    return gate_b * y


def forgetting_attention(q, k, v, f_logit):
    seq = q.shape[1]
    scale = HEAD_DIM ** -0.5
    c = jnp.cumsum(jax.nn.log_sigmoid(f_logit.astype(jnp.float32)), axis=1)
    c = jnp.transpose(c, (0, 2, 1))
    outs = []
    for blk in range(seq // Q_BLOCK):
        q_lo, q_hi = blk * Q_BLOCK, (blk + 1) * Q_BLOCK
        t = jnp.arange(q_lo, q_hi)[:, None]
        s = jnp.arange(q_hi)[None, :]
        logits = jnp.einsum('bqhd,bkhd->bhqk', q[:, q_lo:q_hi], k[:, :q_hi],
                            preferred_element_type=jnp.float32) * scale
        logits = logits + c[:, :, q_lo:q_hi, None] - c[:, :, None, :q_hi]
        p = jax.nn.softmax(jnp.where(s <= t, logits, NEG_INF), axis=-1)
        outs.append(jnp.einsum('bhqk,bkhd->bqhd', p.astype(v.dtype), v[:, :q_hi]))
    return jnp.concatenate(outs, axis=1)


def alibi_slopes(n_heads):
    return jnp.asarray(2.0 ** (-8.0 * np.arange(1, n_heads + 1) / n_heads), dtype=jnp.float32)


def chunk_block_probs(q, k, bias, visible, q_lo, q_hi):
    scale = HEAD_DIM ** -0.5
    logits = jnp.einsum('bqhd,bkhd->bhqk', q[:, q_lo:q_hi], k[:, :q_hi],
                        preferred_element_type=jnp.float32) * scale + bias
    return jax.nn.softmax(jnp.where(visible, logits, NEG_INF), axis=-1)


def differential_attention(q1, q2, k1, k2, v, lam, lam_init, subln_g):
    seq = q1.shape[1]
    slopes = alibi_slopes(DIFF_HEADS)[:, None, None]
    outs = []
    for blk in range(seq // Q_BLOCK):
        q_lo, q_hi = blk * Q_BLOCK, (blk + 1) * Q_BLOCK
        t = jnp.arange(q_lo, q_hi)[:, None]
        s = jnp.arange(q_hi)[None, :]
        bias = -slopes * jnp.abs(t - s).astype(jnp.float32)
        visible = (s // CHUNK) <= (t // CHUNK)
        p = (chunk_block_probs(q1, k1, bias, visible, q_lo, q_hi)
             - lam * chunk_block_probs(q2, k2, bias, visible, q_lo, q_hi))
        outs.append(jnp.einsum('bhqk,bkhe->bqhe', p.astype(v.dtype), v[:, :q_hi]))
    o = jnp.concatenate(outs, axis=1).astype(jnp.float32)
    o = o * lax.rsqrt(jnp.mean(jnp.square(o), axis=-1, keepdims=True) + RMS_EPS)
    return (o * subln_g * (1.0 - lam_init)).astype(v.dtype)


def hierarchical_moe(x, w_group, b_group, w_expert, b_expert, w_gate, w_up, w_down):
    bsz, seq, dm = x.shape
    n_tok = bsz * seq
    xf = x.reshape(n_tok, dm)
    g_logit = (xf @ w_group + b_group).astype(jnp.float32)
    g_prob = jax.nn.softmax(g_logit, axis=-1)
    g_sel = jnp.argmax(g_logit, axis=-1)
    g_w = jnp.take_along_axis(g_prob, g_sel[:, None], axis=-1)[:, 0]
    e_logit = (xf @ w_expert + b_expert).astype(jnp.float32).reshape(n_tok, N_GROUPS, EXPERTS_PER_GROUP)
    e_in = jnp.take_along_axis(e_logit, g_sel[:, None, None], axis=1)[:, 0]
    top_v, top_i = lax.top_k(e_in, TOP_K)
    top_w = jax.nn.softmax(top_v, axis=-1) * g_w[:, None]
    eid = (g_sel[:, None] * EXPERTS_PER_GROUP + top_i).reshape(-1)
    tok = jnp.repeat(jnp.arange(n_tok), TOP_K)
    wt = top_w.reshape(-1)
    order = jnp.argsort(eid)
    s_eid, s_tok, s_wt = eid[order], tok[order], wt[order]
    counts = jnp.bincount(eid, length=N_EXPERTS)
    padded = (counts + MOE_BLOCK - 1) // MOE_BLOCK * MOE_BLOCK
    pad_end = jnp.cumsum(padded)
    pad_start = pad_end - padded
    start = jnp.cumsum(counts) - counts
    dest = pad_start[s_eid] + jnp.arange(eid.shape[0]) - start[s_eid]
    cap = -(-(n_tok * TOP_K) // MOE_BLOCK) * MOE_BLOCK + N_EXPERTS * MOE_BLOCK
    n_blocks = cap // MOE_BLOCK
    xb = jnp.zeros((cap, dm), x.dtype).at[dest].set(xf[s_tok])
    blk_e = jnp.minimum(jnp.searchsorted(pad_end, jnp.arange(n_blocks) * MOE_BLOCK, side='right'),
                        N_EXPERTS - 1)

    def expert_block(args):
        xblk, e = args
        hid = jax.nn.silu(xblk @ w_gate[e]) * (xblk @ w_up[e])
        return hid @ w_down[e]

    yb = lax.map(expert_block, (xb.reshape(n_blocks, MOE_BLOCK, dm), blk_e)).reshape(cap, dm)
    y = jnp.zeros((n_tok, dm), x.dtype).at[s_tok].add(yb[dest] * s_wt[:, None].astype(x.dtype))
    return y.reshape(bsz, seq, dm)


def setup_inputs(seed: int = 0) -> dict:
    key = jax.random.key(seed)
    ks = jax.random.split(key, 24)
    nrm = jax.random.normal
    f32 = jnp.float32
    even_scale = np.ones((EVEN_IN,), np.float32)
    even_scale[2 * CONV_CH:3 * CONV_CH] = BETA
    even_scale[3 * CONV_CH + 2 * FOX_WIDTH:3 * CONV_CH + 3 * FOX_WIDTH] = BETA
    odd_scale = np.ones((ODD_IN,), np.float32)
    odd_scale[2 * D_MODEL:] = BETA
    return {
        'x': nrm(ks[0], (BATCH, SEQ, D_MODEL), f32),
        'ab_w_in': nrm(ks[1], (N_EVEN, D_MODEL, EVEN_IN), f32) * D_MODEL ** -0.5 * jnp.asarray(even_scale),
        'ab_b_forget': FORGET_BIAS + 0.5 * nrm(ks[2], (N_EVEN, FOX_HEADS), f32),
        'ab_conv_w': nrm(ks[3], (N_EVEN, CONV_CH, CONV_K), f32) * CONV_K ** -0.5,
        'ab_w_out': nrm(ks[4], (N_EVEN, D_MODEL, D_MODEL), f32) * D_MODEL ** -0.5 * BETA,
        'c_w_in': nrm(ks[5], (N_ODD, D_MODEL, ODD_IN), f32) * D_MODEL ** -0.5 * jnp.asarray(odd_scale),
        'c_lam_q1': 0.1 * nrm(ks[6], (N_ODD, HEAD_DIM), f32),
        'c_lam_k1': 0.1 * nrm(ks[7], (N_ODD, HEAD_DIM), f32),
        'c_lam_q2': 0.1 * nrm(ks[8], (N_ODD, HEAD_DIM), f32),
        'c_lam_k2': 0.1 * nrm(ks[9], (N_ODD, HEAD_DIM), f32),
        'c_subln_g': 1.0 + 0.02 * nrm(ks[10], (N_ODD, 2 * HEAD_DIM), f32),
        'c_w_out': nrm(ks[11], (N_ODD, D_MODEL, D_MODEL), f32) * D_MODEL ** -0.5 * BETA,
        'ln_mix_g': 1.0 + 0.02 * nrm(ks[12], (DEPTH, D_MODEL), f32),
        'ln_mix_b': 0.02 * nrm(ks[13], (DEPTH, D_MODEL), f32),
        'ln_ffn_g': 1.0 + 0.02 * nrm(ks[14], (DEPTH, D_MODEL), f32),
        'ln_ffn_b': 0.02 * nrm(ks[15], (DEPTH, D_MODEL), f32),
        'moe_w_group': nrm(ks[16], (DEPTH, D_MODEL, N_GROUPS), f32) * D_MODEL ** -0.5,
        'moe_b_group': 0.01 * nrm(ks[17], (DEPTH, N_GROUPS), f32),
        'moe_w_expert': nrm(ks[18], (DEPTH, D_MODEL, N_EXPERTS), f32) * D_MODEL ** -0.5,
        'moe_b_expert': 0.01 * nrm(ks[19], (DEPTH, N_EXPERTS), f32),
        'moe_w_gate': nrm(ks[20], (DEPTH, N_EXPERTS, D_MODEL, D_EXPERT), f32) * D_MODEL ** -0.5,
        'moe_w_up': nrm(ks[21], (DEPTH, N_EXPERTS, D_MODEL, D_EXPERT), f32) * D_MODEL ** -0.5,
        'moe_w_down': nrm(ks[22], (DEPTH, N_EXPERTS, D_EXPERT, D_MODEL), f32) * D_EXPERT ** -0.5 * BETA,
    }


def reference(x, ab_w_in, ab_b_forget, ab_conv_w, ab_w_out, c_w_in, c_lam_q1, c_lam_k1,
              c_lam_q2, c_lam_k2, c_subln_g, c_w_out, ln_mix_g, ln_mix_b, ln_ffn_g, ln_ffn_b,
              moe_w_group, moe_b_group, moe_w_expert, moe_b_expert, moe_w_gate, moe_w_up,
              moe_w_down):
    bsz, seq, _ = x.shape
    for layer in range(DEPTH):
        i = layer // 2
        if layer % 2 == 0:
            h = x @ ab_w_in[i]
            gate_b = h[..., 0:CONV_CH]
            gate_c = h[..., CONV_CH:2 * CONV_CH]
            xv = h[..., 2 * CONV_CH:3 * CONV_CH]
            off = 3 * CONV_CH
            q = h[..., off:off + FOX_WIDTH].reshape(bsz, seq, FOX_HEADS, HEAD_DIM)
            k = h[..., off + FOX_WIDTH:off + 2 * FOX_WIDTH].reshape(bsz, seq, FOX_HEADS, HEAD_DIM)
            v = h[..., off + 2 * FOX_WIDTH:off + 3 * FOX_WIDTH].reshape(bsz, seq, FOX_HEADS, HEAD_DIM)
            f_logit = h[..., off + 3 * FOX_WIDTH:] + ab_b_forget[i]
            a_out = short_gated_conv(xv, gate_b, gate_c, ab_conv_w[i])
            b_out = forgetting_attention(q, k, v, f_logit).reshape(bsz, seq, FOX_WIDTH)
            mix = jnp.concatenate([a_out, b_out], axis=-1) @ ab_w_out[i]
        else:
            h = x @ c_w_in[i]
            q = h[..., 0:D_MODEL].reshape(bsz, seq, DIFF_HEADS, 2, HEAD_DIM)
            k = h[..., D_MODEL:2 * D_MODEL].reshape(bsz, seq, DIFF_HEADS, 2, HEAD_DIM)
            v = h[..., 2 * D_MODEL:].reshape(bsz, seq, DIFF_HEADS, 2 * HEAD_DIM)
            lam_init = 0.8 - 0.6 * math.exp(-0.3 * layer)
            lam = (jnp.exp(jnp.sum(c_lam_q1[i].astype(jnp.float32) * c_lam_k1[i].astype(jnp.float32)))
                   - jnp.exp(jnp.sum(c_lam_q2[i].astype(jnp.float32) * c_lam_k2[i].astype(jnp.float32)))
                   + lam_init)
            o = differential_attention(q[..., 0, :], q[..., 1, :], k[..., 0, :], k[..., 1, :], v,
                                       lam, lam_init, c_subln_g[i])
            mix = o.reshape(bsz, seq, D_MODEL) @ c_w_out[i]
        x = layer_norm(ALPHA * x + mix, ln_mix_g[layer], ln_mix_b[layer])
        ffn = hierarchical_moe(x, moe_w_group[layer], moe_b_group[layer], moe_w_expert[layer],
                               moe_b_expert[layer], moe_w_gate[layer], moe_w_up[layer],
                               moe_w_down[layer])
        x = layer_norm(ALPHA * x + ffn, ln_ffn_g[layer], ln_ffn_b[layer])
    return x
```

```cpp
#include <hip/hip_runtime.h>
#include <hip/hip_cooperative_groups.h>
#include <cstdio>
#include <cstdint>
namespace cg = cooperative_groups;

#ifndef ONE_LAUNCH
#define ONE_LAUNCH 0
#endif

constexpr int DM = 1024, NBATCH = 16, SEQ = 2048, NTOK = NBATCH * SEQ, DEPTH = 4;
constexpr int HD = 64, CONV_CH = 512, FOXW = 512, NHEAD = 8;
constexpr int EVEN_IN = 3080, ODD_IN = 3072, HLD = 3072;
constexpr int NGRP = 4, EPG = 8, NEXP = 32, DEXP = 512;
constexpr int LCAP = NTOK;
constexpr int MOE_ROWS = 2 * NTOK + NEXP * 256;
constexpr float ALPHA = 1.681792830507429f;
constexpr float LN_EPS = 1e-5f, RMS_EPS = 1e-5f;
constexpr int NTHR = 512;

typedef unsigned short bf16_t;
typedef float f32x4 __attribute__((ext_vector_type(4)));
typedef float f32x2 __attribute__((ext_vector_type(2)));
typedef unsigned u32x4 __attribute__((ext_vector_type(4)));
typedef unsigned u32x2 __attribute__((ext_vector_type(2)));

__device__ __forceinline__ float bf2f(unsigned v) { return __uint_as_float(v << 16); }
__device__ __forceinline__ unsigned f2bf(float f) { unsigned u = __float_as_uint(f); return (u + 0x7fffu + ((u >> 16) & 1u)) >> 16; }
__device__ __forceinline__ unsigned pk2(float lo, float hi) { return f2bf(lo) | (f2bf(hi) << 16); }
__device__ __forceinline__ float wave_sum(float v) {
#pragma unroll
    for (int o = 32; o > 0; o >>= 1) v += __shfl_xor(v, o);
    return v;
}

struct P {
    const float* x; const float* ab_w_in; const float* ab_b_forget; const float* ab_conv_w; const float* ab_w_out;
    const float* c_w_in; const float* c_lam_q1; const float* c_lam_k1; const float* c_lam_q2; const float* c_lam_k2;
    const float* c_subln_g; const float* c_w_out;
    const float* ln_mix_g; const float* ln_mix_b; const float* ln_ffn_g; const float* ln_ffn_b;
    const float* moe_w_group; const float* moe_b_group; const float* moe_w_expert; const float* moe_b_expert;
    const float* moe_w_gate; const float* moe_w_up; const float* moe_w_down;
    float* out;
    int* cnt;
    float* xf;
    bf16_t* xb;
    bf16_t* h;
    float* flog;
    float* cum;
    bf16_t* mix;
    float* pre;
    int* list;
    int* tok_e;
    int* tok_slot;
    float* tok_w;
    bf16_t* hid;
    bf16_t* yb;
};

template <int NB, class AL, class BL, class EP>
__device__ __forceinline__ void sgemm_tile(int K, AL aload, BL bload, EP epi, float* sm) {
    float (*As)[132] = (float (*)[132])sm;
    float (*Bs)[16][64] = (float (*)[16][64])(sm + 16 * 132);
    const int tid = threadIdx.x, tx = tid & 15, ty = tid >> 4;
    float acc[NB][4][4];
#pragma unroll
    for (int w = 0; w < NB; ++w)
#pragma unroll
        for (int i = 0; i < 4; ++i)
#pragma unroll
            for (int j = 0; j < 4; ++j) acc[w][i][j] = 0.f;
    const int ar = tid >> 2, ak = (tid & 3) * 4, bk = tid >> 5, bn = (tid & 31) * 2;
    for (int k0 = 0; k0 < K; k0 += 16) {
        const f32x4 av = aload(ar, k0 + ak);
        f32x2 bv[NB];
#pragma unroll
        for (int w = 0; w < NB; ++w) bv[w] = bload(w, k0 + bk, bn);
        __syncthreads();
        As[ak + 0][ar] = av.x; As[ak + 1][ar] = av.y; As[ak + 2][ar] = av.z; As[ak + 3][ar] = av.w;
#pragma unroll
        for (int w = 0; w < NB; ++w) { Bs[w][bk][bn] = bv[w].x; Bs[w][bk][bn + 1] = bv[w].y; }
        __syncthreads();
#pragma unroll
        for (int kk = 0; kk < 16; ++kk) {
            const f32x4 a = *(const f32x4*)&As[kk][ty * 4];
#pragma unroll
            for (int w = 0; w < NB; ++w) {
                const f32x4 b = *(const f32x4*)&Bs[w][kk][tx * 4];
#pragma unroll
                for (int i = 0; i < 4; ++i) { acc[w][i][0] += a[i] * b.x; acc[w][i][1] += a[i] * b.y; acc[w][i][2] += a[i] * b.z; acc[w][i][3] += a[i] * b.w; }
            }
        }
    }
#pragma unroll
    for (int i = 0; i < 4; ++i)
#pragma unroll
        for (int j = 0; j < 4; ++j) epi(ty * 4 + i, tx * 4 + j, acc[0][i][j], acc[NB - 1][i][j]);
    __syncthreads();
}

__device__ __forceinline__ f32x4 ld_bf16x4(const bf16_t* p) { const u32x2 v = *(const u32x2*)p; return (f32x4){bf2f(v.x & 0xffffu), bf2f(v.x >> 16), bf2f(v.y & 0xffffu), bf2f(v.y >> 16)}; }

enum { PH_PRE = 0, PH_INPROJ, PH_SCANCONV, PH_ATTN, PH_OUTPROJ, PH_LNROUTE, PH_MOEUP, PH_MOEDOWN, PH_COMBINE };

__device__ __forceinline__ void ph_pre(const P& p) {
    const size_t n4 = (size_t)NTOK * DM / 4;
    for (size_t i = (size_t)blockIdx.x * NTHR + threadIdx.x; i < n4; i += (size_t)gridDim.x * NTHR) {
        const f32x4 v = ((const f32x4*)p.x)[i];
        ((u32x2*)p.xb)[i] = (u32x2){pk2(v.x, v.y), pk2(v.z, v.w)};
    }
}

__device__ __forceinline__ void ph_inproj(const P& p, int layer, float* sm) {
    const bool even = !(layer & 1); const int li = layer >> 1;
    const int N = even ? EVEN_IN : ODD_IN;
    const float* W = even ? p.ab_w_in + (size_t)li * DM * EVEN_IN : p.c_w_in + (size_t)li * DM * ODD_IN;
    const float* bfg = p.ab_b_forget + li * 8;
    const int nct = (N + 63) / 64, units = (NTOK / 128) * nct;
    for (int u = blockIdx.x; u < units; u += gridDim.x) {
        const int mt = u / nct, ct = u % nct;
        const bf16_t* A = p.xb + (size_t)mt * 128 * DM;
        auto aload = [&](int r, int k) { return ld_bf16x4(A + (size_t)r * DM + k); };
        auto bload = [&](int, int k, int n) { const int col = ct * 64 + n; return col < N ? *(const f32x2*)(W + (size_t)k * N + col) : (f32x2){0.f, 0.f}; };
        auto epi = [&](int r, int c, float v, float) {
            const int row = mt * 128 + r, col = ct * 64 + c;
            if (col < HLD) p.h[(size_t)row * HLD + col] = (bf16_t)f2bf(v);
            else if (col < N) p.flog[row * 8 + (col - HLD)] = v + bfg[col - HLD];
        };
        sgemm_tile<1>(DM, aload, bload, epi, sm);
    }
}

__device__ __forceinline__ float log_sigmoid(float x) { return fminf(x, 0.f) - log1pf(expf(-fabsf(x))); }

__device__ __forceinline__ void ph_scanconv(const P& p, int layer) {
    const int li = layer >> 1;
    const int lane = threadIdx.x & 63, wave = threadIdx.x >> 6;
    for (int u = blockIdx.x * (NTHR / 64) + wave; u < NBATCH * NHEAD; u += gridDim.x * (NTHR / 64)) {
        const int b = u >> 3, hd = u & 7;
        float loc[32]; float run = 0.f;
#pragma unroll
        for (int j = 0; j < 32; ++j) { const int t = lane * 32 + j; run += log_sigmoid(p.flog[(size_t)(b * SEQ + t) * 8 + hd]); loc[j] = run; }
        float incl = run;
#pragma unroll
        for (int o = 1; o < 64; o <<= 1) { const float n = __shfl_up(incl, o); if (lane >= o) incl += n; }
        const float excl = incl - run;
#pragma unroll
        for (int j = 0; j < 32; ++j) { const int t = lane * 32 + j; p.cum[(size_t)(b * SEQ + t) * 8 + hd] = excl + loc[j]; }
    }
    const float* cw = p.ab_conv_w + (size_t)li * CONV_CH * 3;
    for (size_t i = (size_t)blockIdx.x * NTHR + threadIdx.x; i < (size_t)NTOK * CONV_CH; i += (size_t)gridDim.x * NTHR) {
        const int tok = (int)(i >> 9), c = (int)(i & 511), t = tok & (SEQ - 1);
        const bf16_t* hr = p.h + (size_t)tok * HLD;
        const float u2 = bf2f(hr[512 + c]) * bf2f(hr[1024 + c]);
        const float u1 = t >= 1 ? bf2f(hr[512 + c - HLD]) * bf2f(hr[1024 + c - HLD]) : 0.f;
        const float u0 = t >= 2 ? bf2f(hr[512 + c - 2 * HLD]) * bf2f(hr[1024 + c - 2 * HLD]) : 0.f;
        const float y = u0 * cw[c * 3 + 0] + u1 * cw[c * 3 + 1] + u2 * cw[c * 3 + 2];
        p.mix[(size_t)tok * DM + c] = (bf16_t)f2bf(bf2f(hr[c]) * y);
    }
}

template <class BiasF>
__device__ __forceinline__ void attn_row(const bf16_t* qrow, const bf16_t* kbase, const bf16_t* vbase, int s_end, BiasF bias, float (&acc)[32], float& l) {
    float q[64];
#pragma unroll
    for (int d = 0; d < 64; d += 4) { const f32x4 v = ld_bf16x4(qrow + d); q[d] = v.x; q[d + 1] = v.y; q[d + 2] = v.z; q[d + 3] = v.w; }
#pragma unroll
    for (int j = 0; j < 32; ++j) acc[j] = 0.f;
    float m = -1e30f; l = 0.f;
    for (int s = 0; s < s_end; ++s) {
        const bf16_t* kr = kbase + (size_t)s * HLD;
        float dot = 0.f;
#pragma unroll
        for (int d = 0; d < 64; d += 4) { const f32x4 kv = ld_bf16x4(kr + d); dot += q[d] * kv.x + q[d + 1] * kv.y + q[d + 2] * kv.z + q[d + 3] * kv.w; }
        bool valid; const float bb = bias(s, valid);
        if (valid) {
            const float xv = dot * 0.125f + bb;
            const float mn = fmaxf(m, xv), corr = __expf(m - mn), pe = __expf(xv - mn);
            l = l * corr + pe; m = mn;
            const bf16_t* vr = vbase + (size_t)s * HLD;
#pragma unroll
            for (int j = 0; j < 32; j += 4) { const f32x4 vv = ld_bf16x4(vr + j); acc[j] = acc[j] * corr + pe * vv.x; acc[j + 1] = acc[j + 1] * corr + pe * vv.y; acc[j + 2] = acc[j + 2] * corr + pe * vv.z; acc[j + 3] = acc[j + 3] * corr + pe * vv.w; }
        }
    }
}

__device__ __forceinline__ void ph_attn(const P& p, int layer, float* sm) {
    const int tid = threadIdx.x;
    if (!(layer & 1)) {
        const int units = NBATCH * NHEAD * (SEQ / 256);
        for (int u = blockIdx.x; u < units; u += gridDim.x) {
            const int qb = u & 7, hd = (u >> 3) & 7, b = u >> 6;
            const int slice = tid >> 8, row = tid & 255, t = qb * 256 + row;
            const size_t tok = (size_t)b * SEQ + t;
            const bf16_t* hb = p.h + (size_t)b * SEQ * HLD;
            const float* cb = p.cum + (size_t)b * SEQ * 8 + hd;
            const float ct = cb[(size_t)t * 8];
            float acc[32], l;
            auto bias = [&](int s, bool& valid) { valid = s <= t; return ct - cb[(size_t)s * 8]; };
            attn_row(hb + (size_t)t * HLD + 1536 + hd * 64, hb + 2048 + hd * 64, hb + 2560 + hd * 64 + slice * 32, qb * 256 + (row | 63) + 1, bias, acc, l);
            const float inv = 1.f / l;
            bf16_t* o = p.mix + tok * DM + 512 + hd * 64 + slice * 32;
#pragma unroll
            for (int j = 0; j < 32; j += 2) *(unsigned*)(o + j) = pk2(acc[j] * inv, acc[j + 1] * inv);
        }
    } else {
        const int li = layer >> 1;
        const float lam_init = 0.8f - 0.6f * expf(-0.3f * (float)layer);
        float d1 = 0.f, d2 = 0.f;
        for (int d = 0; d < 64; ++d) { d1 += p.c_lam_q1[li * 64 + d] * p.c_lam_k1[li * 64 + d]; d2 += p.c_lam_q2[li * 64 + d] * p.c_lam_k2[li * 64 + d]; }
        const float lam = expf(d1) - expf(d2) + lam_init;
        float* ex = sm;
        float* ssq = sm + 4 * 64 * 33;
        const int units = NBATCH * NHEAD * (SEQ / 64);
        for (int u = blockIdx.x; u < units; u += gridDim.x) {
            const int qb = u & 31, hd = (u >> 5) & 7, b = u >> 8;
            const int j2 = tid >> 8, slice = (tid >> 6) & 3, row = tid & 63, t = qb * 64 + row;
            const size_t tok = (size_t)b * SEQ + t;
            const bf16_t* hb = p.h + (size_t)b * SEQ * HLD;
            const float slope = exp2f(-(float)(hd + 1));
            float acc[32], l;
            auto bias = [&](int s, bool& valid) { valid = true; return -slope * fabsf((float)(t - s)); };
            attn_row(hb + (size_t)t * HLD + hd * 128 + j2 * 64, hb + 1024 + hd * 128 + j2 * 64, hb + 2048 + hd * 128 + slice * 32, (qb + 1) * 64, bias, acc, l);
            const float inv = 1.f / l;
            if (j2 == 1) {
#pragma unroll
                for (int j = 0; j < 32; ++j) ex[(slice * 64 + row) * 33 + j] = acc[j] * inv;
            }
            __syncthreads();
            float part = 0.f;
            if (j2 == 0) {
#pragma unroll
                for (int j = 0; j < 32; ++j) { acc[j] = acc[j] * inv - lam * ex[(slice * 64 + row) * 33 + j]; part += acc[j] * acc[j]; }
                ssq[slice * 64 + row] = part;
            }
            __syncthreads();
            if (j2 == 0) {
                const float tot = ssq[row] + ssq[64 + row] + ssq[128 + row] + ssq[192 + row];
                const float r = rsqrtf(tot * (1.f / 128.f) + RMS_EPS) * (1.f - lam_init);
                const float* g = p.c_subln_g + li * 128 + slice * 32;
                bf16_t* o = p.mix + tok * DM + hd * 128 + slice * 32;
#pragma unroll
                for (int j = 0; j < 32; j += 2) *(unsigned*)(o + j) = pk2(acc[j] * r * g[j], acc[j + 1] * r * g[j + 1]);
            }
            __syncthreads();
        }
    }
}

__device__ __forceinline__ void ph_outproj(const P& p, int layer, float* sm) {
    const bool even = !(layer & 1); const int li = layer >> 1;
    const float* W = (even ? p.ab_w_out : p.c_w_out) + (size_t)li * DM * DM;
    const float* xres = layer == 0 ? p.x : p.xf;
    const int nct = DM / 64, units = (NTOK / 128) * nct;
    for (int u = blockIdx.x; u < units; u += gridDim.x) {
        const int mt = u / nct, ct = u % nct;
        const bf16_t* A = p.mix + (size_t)mt * 128 * DM;
        auto aload = [&](int r, int k) { return ld_bf16x4(A + (size_t)r * DM + k); };
        auto bload = [&](int, int k, int n) { return *(const f32x2*)(W + (size_t)k * DM + ct * 64 + n); };
        auto epi = [&](int r, int c, float v, float) { const size_t o = (size_t)(mt * 128 + r) * DM + ct * 64 + c; p.pre[o] = ALPHA * xres[o] + v; };
        sgemm_tile<1>(DM, aload, bload, epi, sm);
    }
}

__device__ __forceinline__ void ln_row(f32x4 (&v)[4], const float* g, const float* bta, int lane) {
    float s = 0.f;
#pragma unroll
    for (int j = 0; j < 4; ++j) s += (v[j].x + v[j].y) + (v[j].z + v[j].w);
    const float mean = wave_sum(s) * (1.f / DM);
    float s2 = 0.f;
#pragma unroll
    for (int j = 0; j < 4; ++j) { v[j] = v[j] - mean; s2 += (v[j].x * v[j].x + v[j].y * v[j].y) + (v[j].z * v[j].z + v[j].w * v[j].w); }
    const float rstd = rsqrtf(wave_sum(s2) * (1.f / DM) + LN_EPS);
#pragma unroll
    for (int j = 0; j < 4; ++j) { const f32x4 gg = *(const f32x4*)(g + j * 256 + lane * 4), bb = *(const f32x4*)(bta + j * 256 + lane * 4); v[j] = v[j] * rstd * gg + bb; }
}

__device__ __forceinline__ void ph_lnroute(const P& p, int layer) {
    const int lane = threadIdx.x & 63, wave = threadIdx.x >> 6;
    const float* g = p.ln_mix_g + layer * DM; const float* bta = p.ln_mix_b + layer * DM;
    const float* wg = p.moe_w_group + (size_t)layer * DM * NGRP; const float* we = p.moe_w_expert + (size_t)layer * DM * NEXP;
    const float* bg = p.moe_b_group + layer * NGRP; const float* be = p.moe_b_expert + layer * NEXP;
    int* cnt = p.cnt + layer * NEXP;
    for (int row = blockIdx.x * (NTHR / 64) + wave; row < NTOK; row += gridDim.x * (NTHR / 64)) {
        f32x4 v[4];
#pragma unroll
        for (int j = 0; j < 4; ++j) v[j] = *(const f32x4*)(p.pre + (size_t)row * DM + j * 256 + lane * 4);
        ln_row(v, g, bta, lane);
#pragma unroll
        for (int j = 0; j < 4; ++j) {
            *(f32x4*)(p.xf + (size_t)row * DM + j * 256 + lane * 4) = v[j];
            *(u32x2*)(p.xb + (size_t)row * DM + j * 256 + lane * 4) = (u32x2){pk2(v[j].x, v[j].y), pk2(v[j].z, v[j].w)};
        }
        float lg[NGRP + NEXP];
#pragma unroll
        for (int c = 0; c < NGRP + NEXP; ++c) lg[c] = 0.f;
#pragma unroll
        for (int j = 0; j < 4; ++j)
#pragma unroll
            for (int e = 0; e < 4; ++e) {
                const int k = j * 256 + lane * 4 + e; const float xv = v[j][e];
                const f32x4 w4 = *(const f32x4*)(wg + (size_t)k * NGRP);
                lg[0] += xv * w4.x; lg[1] += xv * w4.y; lg[2] += xv * w4.z; lg[3] += xv * w4.w;
#pragma unroll
                for (int c = 0; c < NEXP; c += 4) { const f32x4 w = *(const f32x4*)(we + (size_t)k * NEXP + c); lg[4 + c] += xv * w.x; lg[5 + c] += xv * w.y; lg[6 + c] += xv * w.z; lg[7 + c] += xv * w.w; }
            }
#pragma unroll
        for (int c = 0; c < NGRP + NEXP; ++c) lg[c] = wave_sum(lg[c]);
        float gl[NGRP]; float gm = -3.0e38f; int gs = 0;
#pragma unroll
        for (int c = 0; c < NGRP; ++c) { gl[c] = lg[c] + bg[c]; if (gl[c] > gm) { gm = gl[c]; gs = c; } }
        float gsum = 0.f;
#pragma unroll
        for (int c = 0; c < NGRP; ++c) gsum += expf(gl[c] - gm);
        const float gw = 1.f / gsum;
        float el[EPG];
#pragma unroll
        for (int c = 0; c < EPG; ++c) {
            float val = 0.f;
#pragma unroll
            for (int q = 0; q < NGRP; ++q) val = (q == gs) ? lg[4 + q * EPG + c] + be[q * EPG + c] : val;
            el[c] = val;
        }
        float v0 = -3.0e38f; int i0 = 0;
#pragma unroll
        for (int c = 0; c < EPG; ++c) if (el[c] > v0) { v0 = el[c]; i0 = c; }
        float v1 = -3.0e38f; int i1 = 0;
#pragma unroll
        for (int c = 0; c < EPG; ++c) if (c != i0 && el[c] > v1) { v1 = el[c]; i1 = c; }
        const float e1 = expf(v1 - v0), w0 = gw / (1.f + e1), w1 = gw * e1 / (1.f + e1);
        if (lane == 0) {
            const int ea = gs * EPG + i0, eb = gs * EPG + i1;
            const int sa = atomicAdd(cnt + ea, 1), sb = atomicAdd(cnt + eb, 1);
            p.list[(size_t)ea * LCAP + sa] = row; p.list[(size_t)eb * LCAP + sb] = row;
            p.tok_e[row * 2] = ea; p.tok_e[row * 2 + 1] = eb; p.tok_slot[row * 2] = sa; p.tok_slot[row * 2 + 1] = sb;
            p.tok_w[row * 2] = w0; p.tok_w[row * 2 + 1] = w1;
        }
    }
}

__device__ __forceinline__ void moe_tables(const P& p, int layer, int* tb) {
    if (threadIdx.x == 0) {
        int ps = 0, ts = 0;
        for (int e = 0; e < NEXP; ++e) { const int c = p.cnt[layer * NEXP + e]; tb[e] = c; tb[32 + e] = ps; tb[64 + e] = ts; ps += (c + 255) / 256 * 256; ts += (c + 127) / 128; }
        tb[64 + 32] = ts;
    }
    __syncthreads();
}

__device__ __forceinline__ void ph_moeup(const P& p, int layer, float* sm, int* tb) {
    moe_tables(p, layer, tb);
    const int ntile = tb[96], units = ntile * (DEXP / 64);
    for (int u = blockIdx.x; u < units; u += gridDim.x) {
        const int ti = u >> 3, ct = u & 7;
        int e = 0;
        for (int q = 1; q < NEXP; ++q) if (tb[64 + q] <= ti) e = q;
        const int rt = ti - tb[64 + e], cn = tb[e], ps = tb[32 + e];
        const int myr = rt * 128 + (threadIdx.x >> 2);
        const int mytok = myr < cn ? p.list[(size_t)e * LCAP + myr] : -1;
        const float* Wg = p.moe_w_gate + ((size_t)(layer * NEXP + e) * DM) * DEXP + ct * 64;
        const float* Wu = p.moe_w_up + ((size_t)(layer * NEXP + e) * DM) * DEXP + ct * 64;
        auto aload = [&](int, int k) { return mytok >= 0 ? ld_bf16x4(p.xb + (size_t)mytok * DM + k) : (f32x4){0.f, 0.f, 0.f, 0.f}; };
        auto bload = [&](int w, int k, int n) { return *(const f32x2*)((w ? Wu : Wg) + (size_t)k * DEXP + n); };
        auto epi = [&](int r, int c, float gv, float uv) {
            const int rr = rt * 128 + r;
            if (rr < cn) p.hid[(size_t)(ps + rr) * DEXP + ct * 64 + c] = (bf16_t)f2bf(gv / (1.f + expf(-gv)) * uv);
        };
        sgemm_tile<2>(DM, aload, bload, epi, sm);
    }
}

__device__ __forceinline__ void ph_moedown(const P& p, int layer, float* sm, int* tb) {
    moe_tables(p, layer, tb);
    const int ntile = tb[96], units = ntile * (DM / 64);
    for (int u = blockIdx.x; u < units; u += gridDim.x) {
        const int ti = u >> 4, ct = u & 15;
        int e = 0;
        for (int q = 1; q < NEXP; ++q) if (tb[64 + q] <= ti) e = q;
        const int rt = ti - tb[64 + e], cn = tb[e], ps = tb[32 + e];
        const bf16_t* A = p.hid + (size_t)(ps + rt * 128) * DEXP;
        const float* W = p.moe_w_down + ((size_t)(layer * NEXP + e) * DEXP) * DM + ct * 64;
        auto aload = [&](int r, int k) { return (rt * 128 + r) < cn ? ld_bf16x4(A + (size_t)r * DEXP + k) : (f32x4){0.f, 0.f, 0.f, 0.f}; };
        auto bload = [&](int, int k, int n) { return *(const f32x2*)(W + (size_t)k * DM + n); };
        auto epi = [&](int r, int c, float v, float) { const int rr = rt * 128 + r; if (rr < cn) p.yb[(size_t)(ps + rr) * DM + ct * 64 + c] = (bf16_t)f2bf(v); };
        sgemm_tile<1>(DEXP, aload, bload, epi, sm);
    }
}

__device__ __forceinline__ void ph_combine(const P& p, int layer, int* tb) {
    moe_tables(p, layer, tb);
    const int lane = threadIdx.x & 63, wave = threadIdx.x >> 6;
    const float* g = p.ln_ffn_g + layer * DM; const float* bta = p.ln_ffn_b + layer * DM;
    float* dst = layer == DEPTH - 1 ? p.out : p.xf;
    for (int row = blockIdx.x * (NTHR / 64) + wave; row < NTOK; row += gridDim.x * (NTHR / 64)) {
        const int ea = p.tok_e[row * 2], eb = p.tok_e[row * 2 + 1];
        const size_t da = (size_t)(tb[32 + ea] + p.tok_slot[row * 2]), db = (size_t)(tb[32 + eb] + p.tok_slot[row * 2 + 1]);
        const float w0 = p.tok_w[row * 2], w1 = p.tok_w[row * 2 + 1];
        f32x4 v[4];
#pragma unroll
        for (int j = 0; j < 4; ++j) {
            const f32x4 xv = *(const f32x4*)(p.xf + (size_t)row * DM + j * 256 + lane * 4);
            const f32x4 ya = ld_bf16x4(p.yb + da * DM + j * 256 + lane * 4), yc = ld_bf16x4(p.yb + db * DM + j * 256 + lane * 4);
            v[j] = xv * ALPHA + ya * w0 + yc * w1;
        }
        ln_row(v, g, bta, lane);
#pragma unroll
        for (int j = 0; j < 4; ++j) {
            *(f32x4*)(dst + (size_t)row * DM + j * 256 + lane * 4) = v[j];
            *(u32x2*)(p.xb + (size_t)row * DM + j * 256 + lane * 4) = (u32x2){pk2(v[j].x, v[j].y), pk2(v[j].z, v[j].w)};
        }
    }
}

constexpr int SM_FLOATS = 4 * 64 * 33 + 256;
__device__ __forceinline__ void run_phase(const P& p, int phase, int layer, float* sm, int* tb) {
    switch (phase) {
        case PH_PRE: ph_pre(p); break;
        case PH_INPROJ: ph_inproj(p, layer, sm); break;
        case PH_SCANCONV: ph_scanconv(p, layer); break;
        case PH_ATTN: ph_attn(p, layer, sm); break;
        case PH_OUTPROJ: ph_outproj(p, layer, sm); break;
        case PH_LNROUTE: ph_lnroute(p, layer); break;
        case PH_MOEUP: ph_moeup(p, layer, sm, tb); break;
        case PH_MOEDOWN: ph_moedown(p, layer, sm, tb); break;
        case PH_COMBINE: ph_combine(p, layer, tb); break;
    }
}

__global__ void __launch_bounds__(NTHR) k_phase(P p, int phase, int layer) {
    __shared__ __attribute__((aligned(16))) float sm[SM_FLOATS];
    __shared__ int tb[128];
    run_phase(p, phase, layer, sm, tb);
}

#if ONE_LAUNCH
__global__ void __launch_bounds__(NTHR) k_mega(P p) {
    __shared__ __attribute__((aligned(16))) float sm[SM_FLOATS];
    __shared__ int tb[128];
    cg::grid_group grid = cg::this_grid();
    run_phase(p, PH_PRE, 0, sm, tb); grid.sync();
    for (int layer = 0; layer < DEPTH; ++layer) {
        run_phase(p, PH_INPROJ, layer, sm, tb); grid.sync();
        if (!(layer & 1)) { run_phase(p, PH_SCANCONV, layer, sm, tb); grid.sync(); }
        run_phase(p, PH_ATTN, layer, sm, tb); grid.sync();
        run_phase(p, PH_OUTPROJ, layer, sm, tb); grid.sync();
        run_phase(p, PH_LNROUTE, layer, sm, tb); grid.sync();
        run_phase(p, PH_MOEUP, layer, sm, tb); grid.sync();
        run_phase(p, PH_MOEDOWN, layer, sm, tb); grid.sync();
        run_phase(p, PH_COMBINE, layer, sm, tb);
        if (layer != DEPTH - 1) grid.sync();
    }
}
#endif

extern "C" void kernel_launch(void* const* d_in, const int* in_sizes, int n_in, void* d_out, int out_size, void* d_ws, size_t ws_size, hipStream_t stream) {
    constexpr size_t MiB = 1u << 20;
    constexpr size_t O_CNT = 0, O_XF = 1 * MiB, O_XB = O_XF + 128 * MiB, O_H = O_XB + 64 * MiB, O_FLOG = O_H + 192 * MiB, O_CUM = O_FLOG + 1 * MiB,
                     O_MIX = O_CUM + 1 * MiB, O_PRE = O_MIX + 64 * MiB, O_LIST = O_PRE + 128 * MiB, O_TE = O_LIST + 4 * MiB, O_TS = O_TE + MiB / 4, O_TW = O_TS + MiB / 4,
                     O_HID = O_TW + MiB / 2, O_YB = O_HID + (size_t)MOE_ROWS * DEXP * 2, O_END = O_YB + (size_t)MOE_ROWS * DM * 2;
    if (n_in != 23 || ws_size < O_END || out_size != NTOK * DM) { fprintf(stderr, "kernel_launch: unexpected arguments (n_in %d, ws %zu need %zu, out %d)\n", n_in, ws_size, (size_t)O_END, out_size); return; }
    P p{};
    const float** fp = (const float**)&p;
    for (int i = 0; i < 23; ++i) fp[i] = (const float*)d_in[i];
    p.out = (float*)d_out;
    char* ws = (char*)d_ws;
    p.cnt = (int*)(ws + O_CNT); p.xf = (float*)(ws + O_XF); p.xb = (bf16_t*)(ws + O_XB); p.h = (bf16_t*)(ws + O_H); p.flog = (float*)(ws + O_FLOG); p.cum = (float*)(ws + O_CUM);
    p.mix = (bf16_t*)(ws + O_MIX); p.pre = (float*)(ws + O_PRE); p.list = (int*)(ws + O_LIST); p.tok_e = (int*)(ws + O_TE); p.tok_slot = (int*)(ws + O_TS); p.tok_w = (float*)(ws + O_TW);
    p.hid = (bf16_t*)(ws + O_HID); p.yb = (bf16_t*)(ws + O_YB);
    (void)hipMemsetAsync(ws + O_CNT, 0, 4096, stream);
#if ONE_LAUNCH
    static int grid_blocks = 0;
    if (!grid_blocks) {
        int dev = 0, cus = 0, per_cu = 0;
        hipGetDevice(&dev); hipDeviceGetAttribute(&cus, hipDeviceAttributeMultiprocessorCount, dev);
        hipOccupancyMaxActiveBlocksPerMultiprocessor(&per_cu, k_mega, NTHR, 0);
        if (per_cu > 2) per_cu = 2;
        grid_blocks = cus * per_cu;
        fprintf(stderr, "kernel_launch: cus %d per_cu %d grid %d\n", cus, per_cu, grid_blocks);
    }
    void* args[] = {&p};
    hipError_t e = hipLaunchCooperativeKernel((void*)k_mega, dim3(grid_blocks), dim3(NTHR), args, 0, stream);
    if (e != hipSuccess) fprintf(stderr, "cooperative launch failed: %s (grid %d)\n", hipGetErrorString(e), grid_blocks);
#else
    const int G = 1024;
    auto L = [&](int phase, int layer) { hipLaunchKernelGGL(k_phase, dim3(G), dim3(NTHR), 0, stream, p, phase, layer); };
    L(PH_PRE, 0);
    for (int layer = 0; layer < DEPTH; ++layer) {
        L(PH_INPROJ, layer);
        if (!(layer & 1)) L(PH_SCANCONV, layer);
        L(PH_ATTN, layer); L(PH_OUTPROJ, layer); L(PH_LNROUTE, layer); L(PH_MOEUP, layer); L(PH_MOEDOWN, layer); L(PH_COMBINE, layer);
    }
#endif
}
```
